# Optimizing an MI355X kernel written in HIP

```python
import jax, jax.numpy as jnp
from jax import lax
import numpy as np

D_MODEL = 1024
BATCH = 2
SEQ = 8192
DEPTH = 1

D_PLE = 256
D_MIX = 2 * D_MODEL
ATT_HEADS = 16
ATT_KV_HEADS = 2
ATT_HEAD_DIM = 64
ATT_WIDTH = ATT_HEADS * ATT_HEAD_DIM
ATT_KV_WIDTH = ATT_KV_HEADS * ATT_HEAD_DIM
WINDOW = 128
BLOCK = 128
ROPE_DIM = ATT_HEAD_DIM // 4
ROPE_THETA = 500000.0
GLA_WIDTH = D_MIX - ATT_WIDTH
GLA_HEADS = 4
GLA_V_DIM = GLA_WIDTH // GLA_HEADS
GLA_K_DIM = GLA_V_DIM // 2
GLA_QK_WIDTH = GLA_HEADS * GLA_K_DIM
GLA_GATE_RANK = 16
GLA_GATE_NORMALIZER = 16.0
GLA_CHUNK = 64
EPS = 1e-6
SPLITS = (ATT_WIDTH, ATT_KV_WIDTH, ATT_KV_WIDTH,
          GLA_QK_WIDTH, GLA_QK_WIDTH, GLA_WIDTH,
          GLA_GATE_RANK,
          ATT_WIDTH, GLA_WIDTH)
D_IN_PROJ = sum(SPLITS)

kernel_name = 'hymba_swa_sink_gla_ple_block'


def rmsnorm(x, g):
    xf = x.astype(jnp.float32)
    y = xf * lax.rsqrt(jnp.mean(xf * xf, axis=-1, keepdims=True) + EPS)
    return (y * g.astype(jnp.float32)).astype(x.dtype)


def partial_rope(x, positions):
    half = ROPE_DIM // 2
    inv_freq = ROPE_THETA ** (-jnp.arange(0, ROPE_DIM, 2, dtype=jnp.float32) / ROPE_DIM)
    ang = positions.astype(jnp.float32)[..., None] * inv_freq
    cos = jnp.cos(ang)[:, :, None, :].astype(x.dtype)
    sin = jnp.sin(ang)[:, :, None, :].astype(x.dtype)
    x1 = x[..., :half]
    x2 = x[..., half:ROPE_DIM]
    return jnp.concatenate([x1 * cos - x2 * sin, x2 * cos + x1 * sin, x[..., ROPE_DIM:]], axis=-1)


def swa_sink_attention(q, k, v, sinks):
    B, S, H, dh = q.shape
    nb = S // BLOCK
    G = H // ATT_KV_HEADS
    qb = q.reshape(B, nb, BLOCK, ATT_KV_HEADS, G, dh)
    kb = k.reshape(B, nb, BLOCK, ATT_KV_HEADS, dh)
    vb = v.reshape(B, nb, BLOCK, ATT_KV_HEADS, dh)
    pad = jnp.zeros_like(kb[:, :1])
    kk = jnp.concatenate([jnp.concatenate([pad, kb[:, :-1]], axis=1), kb], axis=2)
    vv = jnp.concatenate([jnp.concatenate([pad, vb[:, :-1]], axis=1), vb], axis=2)
    s = jnp.einsum('bnqhgd,bnkhd->bnhgqk', qb, kk).astype(jnp.float32) * (dh ** -0.5)
    qi = jnp.arange(BLOCK)[:, None]
    kj = jnp.arange(2 * BLOCK)[None, :]
    diff = qi + BLOCK - kj
    band = (diff >= 0) & (diff < WINDOW)
    blk = jnp.arange(nb)[:, None, None]
    mask = band[None] & ((blk > 0) | (kj >= BLOCK)[None])
    s = jnp.where(mask[None, :, None, None], s, -jnp.inf)
    sink = sinks.astype(jnp.float32).reshape(ATT_KV_HEADS, G)[None, None, :, :, None, None]
    m = jnp.maximum(jnp.max(s, axis=-1, keepdims=True), sink)
    e = jnp.exp(s - m)
    pr = (e / (jnp.sum(e, axis=-1, keepdims=True) + jnp.exp(sink - m))).astype(v.dtype)
    o = jnp.einsum('bnhgqk,bnkhd->bnqhgd', pr, vv)
    return o.reshape(B, S, H * dh)


def gla_chunked(q, k, v, log_g):
    B, S, H, dk = q.shape
    dv = v.shape[-1]
    nc = S // GLA_CHUNK
    f = lambda t: t.astype(jnp.float32).reshape(B, nc, GLA_CHUNK, H, t.shape[-1])
    qf = f(q) * (dk ** -0.5)
    kf = f(k)
    vf = f(v)
    b = jnp.cumsum(f(log_g), axis=2)
    b_last = b[:, :, -1]
    q_dec = qf * jnp.exp(b)
    k_inv = kf * jnp.exp(-b)
    k_tail = kf * jnp.exp(b_last[:, :, None] - b)
    causal = jnp.tril(jnp.ones((GLA_CHUNK, GLA_CHUNK), dtype=bool))
    a = jnp.where(causal, jnp.einsum('bnihd,bnjhd->bnhij', q_dec, k_inv), 0.0)
    o_intra = jnp.einsum('bnhij,bnjhv->bnihv', a, vf)
    kv = jnp.einsum('bnjhd,bnjhv->bnhdv', k_tail, vf)
    decay = jnp.exp(b_last)

    def step(state, inp):
        dec, kvc = inp
        return dec[..., None] * state + kvc, state

    init = jnp.zeros((B, H, dk, dv), jnp.float32)
    _, s_prev = lax.scan(step, init, (jnp.moveaxis(decay, 1, 0), jnp.moveaxis(kv, 1, 0)))
    s_prev = jnp.moveaxis(s_prev, 0, 1)
    o_inter = jnp.einsum('bnihd,bnhdv->bnihv', q_dec, s_prev)
    return (o_intra + o_inter).reshape(B, S, H, dv)


def setup_inputs(seed: int = 0) -> dict:
    key = jax.random.key(seed)
    ks = jax.random.split(key, 16)
    nrm = lambda k, shape, scale: jax.random.normal(k, shape, jnp.float32) * scale
    x = nrm(ks[0], (BATCH, SEQ, D_MODEL), 1.0)
    p = nrm(ks[1], (DEPTH, BATCH, SEQ, D_PLE), 1.0)
    positions = jnp.broadcast_to(jnp.arange(SEQ, dtype=jnp.int32), (BATCH, SEQ))
    return {
        'x': x,
        'p': p,
        'positions': positions,
        'norm_mix': 1.0 + nrm(ks[2], (DEPTH, D_MODEL), 0.02),
        'w_in': nrm(ks[3], (DEPTH, D_MODEL, D_IN_PROJ), D_MODEL ** -0.5),
        'attn_sinks': nrm(ks[4], (DEPTH, ATT_HEADS), 0.5),
        'w_gate_up': nrm(ks[5], (DEPTH, GLA_GATE_RANK, GLA_QK_WIDTH), GLA_GATE_RANK ** -0.5),
        'b_gate': nrm(ks[6], (DEPTH, GLA_QK_WIDTH), 0.1),
        'gla_norm': 1.0 + nrm(ks[7], (DEPTH, GLA_V_DIM), 0.02),
        'w_out': nrm(ks[8], (DEPTH, D_MIX, D_MODEL), D_MIX ** -0.5),
        'ple_norm': 1.0 + nrm(ks[9], (DEPTH, D_MODEL), 0.02),
        'w_ple_gate': nrm(ks[10], (DEPTH, D_MODEL, D_MODEL), D_MODEL ** -0.5),
        'w_ple_proj': nrm(ks[11], (DEPTH, D_PLE, D_MODEL), D_PLE ** -0.5),
        'final_norm': 1.0 + nrm(ks[12], (D_MODEL,), 0.02),
    }


def reference(x, p, positions, norm_mix, w_in, attn_sinks, w_gate_up, b_gate, gla_norm,
              w_out, ple_norm, w_ple_gate, w_ple_proj, final_norm):
    B, S, _ = x.shape
    offsets = []
    acc = 0
    for n in SPLITS[:-1]:
        acc += n
        offsets.append(acc)
    h = x
    for i in range(DEPTH):
        u = rmsnorm(h, norm_mix[i])
        z = u @ w_in[i]
        aq, ak, av, gq, gk, gv, g_low, za, zg = jnp.split(z, offsets, axis=-1)
        aq = partial_rope(aq.reshape(B, S, ATT_HEADS, ATT_HEAD_DIM), positions)
        ak = partial_rope(ak.reshape(B, S, ATT_KV_HEADS, ATT_HEAD_DIM), positions)
        av = av.reshape(B, S, ATT_KV_HEADS, ATT_HEAD_DIM)
        y_att = swa_sink_attention(aq, ak, av, attn_sinks[i])
        log_g = jax.nn.log_sigmoid((g_low @ w_gate_up[i] + b_gate[i]).astype(jnp.float32)) / GLA_GATE_NORMALIZER
        o = gla_chunked(gq.reshape(B, S, GLA_HEADS, GLA_K_DIM),
                        gk.reshape(B, S, GLA_HEADS, GLA_K_DIM),
                        gv.reshape(B, S, GLA_HEADS, GLA_V_DIM),
                        log_g.reshape(B, S, GLA_HEADS, GLA_K_DIM)).astype(x.dtype)
        y_gla = rmsnorm(o, gla_norm[i]).reshape(B, S, GLA_WIDTH)
        y = jnp.concatenate([y_att * jax.nn.silu(za), y_gla * jax.nn.silu(zg)], axis=-1) @ w_out[i]
        h = h + y
        gate = jax.nn.sigmoid(rmsnorm(h, ple_norm[i]) @ w_ple_gate[i])
        h = h + gate * (p[i] @ w_ple_proj[i])
    return rmsnorm(h, final_norm)
```

```cpp
#include <hip/hip_runtime.h>
#include <stdint.h>

namespace {
constexpr int D_MODEL = 1024, BATCH = 2, SEQ = 8192, M = BATCH * SEQ;
constexpr int D_PLE = 256, D_MIX = 2048;
constexpr int ATT_HEADS = 16, ATT_KV_HEADS = 2, HD = 64, WINDOW = 128;
constexpr int GLA_HEADS = 4, GLA_V = 256, GLA_K = 128, GLA_RANK = 16;
constexpr int NZ = 5392;
constexpr int O_AQ = 0, O_AK = 1024, O_AV = 1152, O_GQ = 1280, O_GK = 1792, O_GV = 2304, O_GL = 3328, O_ZA = 3344, O_ZG = 4368;
constexpr float EPS = 1e-6f;

typedef unsigned short bf16_t;
__device__ __forceinline__ float bf2f(bf16_t b) { return __uint_as_float(((unsigned)b) << 16); }
__device__ __forceinline__ bf16_t f2bf(float f) { unsigned u = __float_as_uint(f); return (bf16_t)((u + 0x7fffu + ((u >> 16) & 1u)) >> 16); }
__device__ __forceinline__ float ldf(const float* p) { return *p; }
__device__ __forceinline__ float ldf(const bf16_t* p) { return bf2f(*p); }
__device__ __forceinline__ void stf(float* p, float v) { *p = v; }
__device__ __forceinline__ void stf(bf16_t* p, float v) { *p = f2bf(v); }

__device__ __forceinline__ float block_sum256(float v, float* red) {
    for (int o = 32; o > 0; o >>= 1) v += __shfl_xor(v, o);
    const int w = threadIdx.x >> 6;
    __syncthreads();
    if ((threadIdx.x & 63) == 0) red[w] = v;
    __syncthreads();
    return red[0] + red[1] + red[2] + red[3];
}

__global__ void rmsnorm_rows(const float* x, const float* g, float* out) {
    __shared__ float red[4];
    const size_t row = blockIdx.x;
    const float4 v = ((const float4*)(x + row * D_MODEL))[threadIdx.x];
    float s = v.x * v.x + v.y * v.y + v.z * v.z + v.w * v.w;
    s = block_sum256(s, red);
    const float r = rsqrtf(s * (1.0f / D_MODEL) + EPS);
    const float4 gg = ((const float4*)g)[threadIdx.x];
    float4 o; o.x = v.x * r * gg.x; o.y = v.y * r * gg.y; o.z = v.z * r * gg.z; o.w = v.w * r * gg.w;
    ((float4*)(out + row * D_MODEL))[threadIdx.x] = o;
}

template <typename TA, typename TC>
__global__ void gemm_naive(const TA* A, int lda, const float* B, int ldb, TC* C, int ldc, const float* R, int ldr, int Mm, int N, int K) {
    __shared__ float As[16][65];
    __shared__ float Bs[16][65];
    const int tx = threadIdx.x & 15, ty = threadIdx.x >> 4;
    const int m0 = blockIdx.y * 64, n0 = blockIdx.x * 64;
    float acc[4][4] = {};
    for (int k0 = 0; k0 < K; k0 += 16) {
        for (int i = threadIdx.x; i < 64 * 16; i += 256) {
            const int r = i >> 4, c = i & 15;
            As[c][r] = ldf(A + (size_t)(m0 + r) * lda + k0 + c);
        }
        for (int i = threadIdx.x; i < 16 * 64; i += 256) {
            const int r = i >> 6, c = i & 63;
            Bs[r][c] = (n0 + c < N) ? B[(size_t)(k0 + r) * ldb + n0 + c] : 0.f;
        }
        __syncthreads();
#pragma unroll
        for (int kk = 0; kk < 16; ++kk) {
            float a[4], b[4];
#pragma unroll
            for (int i = 0; i < 4; ++i) { a[i] = As[kk][ty * 4 + i]; b[i] = Bs[kk][tx * 4 + i]; }
#pragma unroll
            for (int i = 0; i < 4; ++i)
#pragma unroll
                for (int j = 0; j < 4; ++j) acc[i][j] += a[i] * b[j];
        }
        __syncthreads();
    }
    for (int i = 0; i < 4; ++i)
        for (int j = 0; j < 4; ++j) {
            const int r = m0 + ty * 4 + i, c = n0 + tx * 4 + j;
            if (c < N) { float v = acc[i][j]; if (R) v += R[(size_t)r * ldr + c]; stf(C + (size_t)r * ldc + c, v); }
        }
}

__global__ void rope_kernel(bf16_t* Z, const int* positions) {
    const int idx = blockIdx.x * blockDim.x + threadIdx.x;
    if (idx >= M * 18 * 8) return;
    const int j = idx & 7, hh = (idx >> 3) % 18, t = idx / (18 * 8);
    const int col = (hh < 16) ? (O_AQ + hh * HD) : (O_AK + (hh - 16) * HD);
    const float inv_freq = powf(500000.0f, -(float)(2 * j) / 16.0f);
    const float ang = (float)positions[t] * inv_freq;
    const float c = cosf(ang), s = sinf(ang);
    bf16_t* p = Z + (size_t)t * NZ + col;
    const float x1 = bf2f(p[j]), x2 = bf2f(p[j + 8]);
    p[j] = f2bf(x1 * c - x2 * s);
    p[j + 8] = f2bf(x2 * c + x1 * s);
}

__global__ void attn_naive(const bf16_t* Z, const float* sinks, bf16_t* Y) {
    const int lane = threadIdx.x;
    const int h = blockIdx.x % ATT_HEADS, t = blockIdx.x / ATT_HEADS;
    const int b = t / SEQ, s = t % SEQ, hk = h / (ATT_HEADS / ATT_KV_HEADS);
    __shared__ float q[HD];
    __shared__ float pr[WINDOW];
    q[lane] = bf2f(Z[(size_t)t * NZ + O_AQ + h * HD + lane]);
    __syncthreads();
    float sc[2];
    for (int i = 0; i < 2; ++i) {
        const int kp = s - 127 + lane + 64 * i;
        float v = -INFINITY;
        if (kp >= 0) {
            const bf16_t* kr = Z + ((size_t)b * SEQ + kp) * NZ + O_AK + hk * HD;
            float a = 0.f;
            for (int d = 0; d < HD; ++d) a += q[d] * bf2f(kr[d]);
            v = a * 0.125f;
        }
        sc[i] = v;
    }
    float m = fmaxf(sc[0], sc[1]);
    for (int o = 32; o > 0; o >>= 1) m = fmaxf(m, __shfl_xor(m, o));
    const float sink = sinks[h];
    m = fmaxf(m, sink);
    const float e0 = expf(sc[0] - m), e1 = expf(sc[1] - m);
    float l = e0 + e1;
    for (int o = 32; o > 0; o >>= 1) l += __shfl_xor(l, o);
    l += expf(sink - m);
    pr[lane] = e0 / l; pr[lane + 64] = e1 / l;
    __syncthreads();
    float o = 0.f;
    for (int i = 0; i < WINDOW; ++i) {
        const int kp = s - 127 + i;
        if (kp >= 0) o += pr[i] * bf2f(Z[((size_t)b * SEQ + kp) * NZ + O_AV + hk * HD + lane]);
    }
    const float za = bf2f(Z[(size_t)t * NZ + O_ZA + h * HD + lane]);
    Y[(size_t)t * D_MIX + h * HD + lane] = f2bf(o * (za / (1.0f + expf(-za))));
}

__global__ void __launch_bounds__(256) gla_naive(const bf16_t* Z, const float* w_gate_up, const float* b_gate, const float* gla_norm, bf16_t* Y) {
    const int b = blockIdx.x / GLA_HEADS, h = blockIdx.x % GLA_HEADS, tid = threadIdx.x;
    __shared__ float al[GLA_K], kk[GLA_K], qq[GLA_K], red[4];
    float S[GLA_K];
#pragma unroll
    for (int d = 0; d < GLA_K; ++d) S[d] = 0.f;
    float wc[GLA_RANK]; float bg = 0.f;
    if (tid < GLA_K) {
#pragma unroll
        for (int r = 0; r < GLA_RANK; ++r) wc[r] = w_gate_up[r * 512 + h * GLA_K + tid]; bg = b_gate[h * GLA_K + tid]; }
    const float gn = gla_norm[tid];
    for (int s = 0; s < SEQ; ++s) {
        const bf16_t* zr = Z + ((size_t)b * SEQ + s) * NZ;
        if (tid < GLA_K) {
            float x = bg;
#pragma unroll
            for (int r = 0; r < GLA_RANK; ++r) x += bf2f(zr[O_GL + r]) * wc[r];
            const float ls = fminf(x, 0.f) - log1pf(expf(-fabsf(x)));
            al[tid] = expf(ls * (1.0f / 16.0f));
            kk[tid] = bf2f(zr[O_GK + h * GLA_K + tid]);
        } else {
            qq[tid - GLA_K] = bf2f(zr[O_GQ + h * GLA_K + tid - GLA_K]) * 0.08838834764831845f;
        }
        __syncthreads();
        const float v = bf2f(zr[O_GV + h * GLA_V + tid]);
        float o = 0.f;
#pragma unroll
        for (int d = 0; d < GLA_K; ++d) { S[d] = al[d] * S[d] + kk[d] * v; o += qq[d] * S[d]; }
        const float ss = block_sum256(o * o, red);
        const float r = rsqrtf(ss * (1.0f / GLA_V) + EPS);
        const float zg = bf2f(zr[O_ZG + h * GLA_V + tid]);
        Y[((size_t)b * SEQ + s) * D_MIX + 1024 + h * GLA_V + tid] = f2bf(o * r * gn * (zg / (1.0f + expf(-zg))));
        __syncthreads();
    }
}

__global__ void final_rows(float* hout, const float* G, const float* PP, const float* fn) {
    __shared__ float red[4];
    const size_t row = blockIdx.x;
    const float4 hv = ((const float4*)(hout + row * D_MODEL))[threadIdx.x];
    const float4 g = ((const float4*)(G + row * D_MODEL))[threadIdx.x];
    const float4 pp = ((const float4*)(PP + row * D_MODEL))[threadIdx.x];
    float4 v;
    v.x = hv.x + pp.x / (1.0f + expf(-g.x)); v.y = hv.y + pp.y / (1.0f + expf(-g.y));
    v.z = hv.z + pp.z / (1.0f + expf(-g.z)); v.w = hv.w + pp.w / (1.0f + expf(-g.w));
    float s = v.x * v.x + v.y * v.y + v.z * v.z + v.w * v.w;
    s = block_sum256(s, red);
    const float r = rsqrtf(s * (1.0f / D_MODEL) + EPS);
    const float4 gg = ((const float4*)fn)[threadIdx.x];
    float4 o; o.x = v.x * r * gg.x; o.y = v.y * r * gg.y; o.z = v.z * r * gg.z; o.w = v.w * r * gg.w;
    ((float4*)(hout + row * D_MODEL))[threadIdx.x] = o;
}
}

extern "C" void kernel_launch(void* const* d_in, const int* in_sizes, int n_in, void* d_out, int out_size, void* d_ws, size_t ws_size, hipStream_t stream) {
    const float* x = (const float*)d_in[0]; const float* p = (const float*)d_in[1]; const int* positions = (const int*)d_in[2];
    const float* norm_mix = (const float*)d_in[3]; const float* w_in = (const float*)d_in[4]; const float* sinks = (const float*)d_in[5];
    const float* w_gate_up = (const float*)d_in[6]; const float* b_gate = (const float*)d_in[7]; const float* gla_norm = (const float*)d_in[8];
    const float* w_out = (const float*)d_in[9]; const float* ple_norm = (const float*)d_in[10]; const float* w_ple_gate = (const float*)d_in[11];
    const float* w_ple_proj = (const float*)d_in[12]; const float* final_norm = (const float*)d_in[13];
    float* out = (float*)d_out; char* ws = (char*)d_ws;
    constexpr size_t MiB = 1u << 20;
    bf16_t* Z = (bf16_t*)ws;
    bf16_t* Y = (bf16_t*)(ws + 170 * MiB);
    float* HN = (float*)ws;
    float* G = (float*)(ws + 64 * MiB);
    float* PP = (float*)(ws + 128 * MiB);

    rmsnorm_rows<<<M, 256, 0, stream>>>(x, norm_mix, out);
    gemm_naive<float, bf16_t><<<dim3((NZ + 63) / 64, M / 64), 256, 0, stream>>>(out, D_MODEL, w_in, NZ, Z, NZ, nullptr, 0, M, NZ, D_MODEL);
    rope_kernel<<<(M * 18 * 8 + 255) / 256, 256, 0, stream>>>(Z, positions);
    attn_naive<<<M * ATT_HEADS, 64, 0, stream>>>(Z, sinks, Y);
    gla_naive<<<BATCH * GLA_HEADS, 256, 0, stream>>>(Z, w_gate_up, b_gate, gla_norm, Y);
    gemm_naive<bf16_t, float><<<dim3(D_MODEL / 64, M / 64), 256, 0, stream>>>(Y, D_MIX, w_out, D_MODEL, out, D_MODEL, x, D_MODEL, M, D_MODEL, D_MIX);
    rmsnorm_rows<<<M, 256, 0, stream>>>(out, ple_norm, HN);
    gemm_naive<float, float><<<dim3(D_MODEL / 64, M / 64), 256, 0, stream>>>(HN, D_MODEL, w_ple_gate, D_MODEL, G, D_MODEL, nullptr, 0, M, D_MODEL, D_MODEL);
    gemm_naive<float, float><<<dim3(D_MODEL / 64, M / 64), 256, 0, stream>>>(p, D_PLE, w_ple_proj, D_MODEL, PP, D_MODEL, nullptr, 0, M, D_MODEL, D_PLE);
    final_rows<<<M, 256, 0, stream>>>(out, G, PP, final_norm);
}
```

```cpp
#include <hip/hip_runtime.h>
#include <cstdio>
#include <cstdint>

#define LAS __attribute__((address_space(3)))
#define GAS __attribute__((address_space(1)))
typedef unsigned short bf16_t;
typedef short bf16x8 __attribute__((ext_vector_type(8)));
typedef float f32x4 __attribute__((ext_vector_type(4)));
typedef float f32x2 __attribute__((ext_vector_type(2)));
typedef float f32x16 __attribute__((ext_vector_type(16)));
typedef unsigned u32x4 __attribute__((ext_vector_type(4)));
typedef unsigned u32x2 __attribute__((ext_vector_type(2)));

constexpr int D_MODEL = 1024, BATCH = 2, SEQ = 8192, M = BATCH * SEQ;
constexpr int D_PLE = 256, D_MIX = 2048;
constexpr int ATT_HEADS = 16, ATT_KV_HEADS = 2, HD = 64;
constexpr int GLA_HEADS = 4, GLA_V = 256, GLA_K = 128, GLA_RANK = 16;
constexpr int NZ_SRC = 5392;
constexpr int NZ_PAD = 5632;
constexpr int ZA_P = 3328;
constexpr int ZY_P = 2048;
constexpr int C_AQ = 0, C_AK = 1024, C_AV = 1152, C_GQ = 1280, C_GK = 1792, C_GV = 2304;
constexpr float EPS = 1e-6f;
constexpr float LOG2E = 1.4426950408889634f;
constexpr float QSCALE = 0.125f * LOG2E;

constexpr size_t MiB = 1u << 20;
constexpr size_t WS_CTL = 0, CTL_ZERO_BYTES = 1 * MiB;
constexpr size_t WS_WIN = 2 * MiB;
constexpr size_t WS_WOUT = 13 * MiB;
constexpr size_t WS_WG = 17 * MiB;
constexpr size_t WS_WP = 19 * MiB;
constexpr size_t WS_ROPE = 19 * MiB + 512 * 1024;
constexpr size_t WS_GLOW = 20 * MiB + 512 * 1024;
constexpr size_t WS_RSS1 = 21 * MiB + 512 * 1024;
constexpr size_t WS_RSS2 = 22 * MiB + 512 * 1024;
constexpr size_t WS_GLAD = 23 * MiB + 512 * 1024;
constexpr size_t WS_XN = 24 * MiB;
constexpr size_t WS_ZA = 56 * MiB;
constexpr size_t WS_HB = 56 * MiB;
constexpr size_t WS_ZY = 160 * MiB;
constexpr size_t WS_PP = 224 * MiB;
constexpr size_t WS_END = 256 * MiB;

constexpr int CW_BAR = 4096;

constexpr int RING_BYTES = 131072;
constexpr int LDSCTL_OFF = RING_BYTES, MISC_OFF = LDSCTL_OFF + 320;
constexpr int LDS_BYTES = 147456;
constexpr int NWAVES = 8;

#define LDS_WAIT() asm volatile("s_waitcnt lgkmcnt(0)" ::: "memory")
#define VM_WAIT() asm volatile("s_waitcnt vmcnt(0)" ::: "memory")
#define RLX_AGENT __ATOMIC_RELAXED, __HIP_MEMORY_SCOPE_AGENT

typedef __bf16 bf16x2_hw __attribute__((ext_vector_type(2)));
__device__ __forceinline__ unsigned cvt_pk_bf16(float lo, float hi) { unsigned r; asm volatile("v_cvt_pk_bf16_f32 %0, %1, %2" : "=v"(r) : "v"(lo), "v"(hi)); return r; }
__device__ __forceinline__ unsigned cvt_pk_bf16_c(float lo, float hi) { const f32x2 v = {lo, hi}; const bf16x2_hw b = __builtin_convertvector(v, bf16x2_hw); return __builtin_bit_cast(unsigned, b); }
__device__ __forceinline__ float bf2f(bf16_t b) { return __uint_as_float(((unsigned)b) << 16); }
__device__ __forceinline__ float bflo(unsigned w) { return __uint_as_float(w << 16); }
__device__ __forceinline__ float bfhi(unsigned w) { return __uint_as_float(w & 0xffff0000u); }
__device__ __forceinline__ unsigned f2bf(float f) { unsigned u = __float_as_uint(f); return (u + 0x7fffu + ((u >> 16) & 1u)) >> 16; }
__device__ __forceinline__ unsigned pk2(float lo, float hi) { return f2bf(lo) | (f2bf(hi) << 16); }
__device__ __forceinline__ float fast_exp2(float x) { return __builtin_amdgcn_exp2f(x); }
__device__ __forceinline__ float fast_rcp(float x) { return __builtin_amdgcn_rcpf(x); }
__device__ __forceinline__ float sigmoid_f(float x) { return fast_rcp(1.0f + fast_exp2(-x * LOG2E)); }
__device__ __forceinline__ float silu_f(float x) { return x * sigmoid_f(x); }

namespace pg8 {
constexpr int BM = 256, BK = 64, HALF = 128, HTB = HALF * BK * 2, STAGE_BYTES = 8 * HTB, NXCD = 8, WGM = 8;
__host__ __device__ __forceinline__ int lds_byte(int r, int c) { const int st = (r >> 4) * 2 + (c >> 5), rr = r & 15, cc = c & 31, ob = rr * 64 + cc * 2; return st * 1024 + (ob ^ (((ob >> 9) & 1) << 5)); }
__host__ __device__ __forceinline__ void stage_rc(int b, int& R, int& C) { const int st = b / 1024, sb = b % 1024, swz = sb ^ (((sb >> 9) & 1) << 5); R = (st >> 1) * 16 + swz / 64; C = (st & 1) * 32 + (swz % 64) / 2; }
__host__ __device__ __forceinline__ int perm32(int rho) { const int n = rho >> 4, i = rho & 15; return 8 * (i >> 2) + 4 * n + (i & 3); }

struct Unit { int pm, pn; };
struct Gemm { const bf16_t* A; const bf16_t* Bt; int lda, ldb, K; };

struct StaticOrder {
    int nM, nN, nwg, G, c;
    __host__ __device__ void init(int M_, int N_, int G_, int c_) { nM = M_ / BM; nN = N_ / BM; nwg = nM * nN; G = G_; c = c_; }
    __host__ __device__ bool next(int i, Unit& u) const {
        const long L = (long)i * G + c; if (L >= nwg) return false;
        int wgid = (int)L; { const int q = nwg / NXCD, r = nwg % NXCD, xcd = wgid % NXCD, off = wgid / NXCD; wgid = (xcd < r ? xcd * (q + 1) : r * (q + 1) + (xcd - r) * q) + off; }
        const int nig = WGM * nN, gid = wgid / nig, fm = gid * WGM, gsz = (nM - fm) < WGM ? (nM - fm) : WGM;
        u.pm = fm + ((wgid % nig) % gsz); u.pn = (wgid % nig) / gsz; return true;
    }
};

template <class Epi, class Sched, bool ALIGN_EPI>
__device__ __forceinline__ void gemm_phase(LAS unsigned char* lds, const Gemm g, const Sched& S, const Epi& E) {
    const int tid = threadIdx.x, wid = __builtin_amdgcn_readfirstlane(tid >> 6), lane = tid & 63, wr = wid >> 2, wc = wid & 3, fr = lane & 15, fq = lane >> 4;
    const int nt = g.K / BK;
    unsigned voffA[2], voffB[2];
#pragma unroll
    for (int i = 0; i < 2; ++i) { int R, C; stage_rc(tid * 16 + i * 8192, R, C); const int Rb = Epi::PERM ? ((R & ~31) + perm32(R & 31)) : R;
        voffA[i] = (unsigned)(R * g.lda + C) * 2u; voffB[i] = (unsigned)(Rb * g.ldb + C) * 2u; }
    const size_t kstep = (size_t)(BK * 2);
    const size_t hstepA = (size_t)HALF * g.lda * 2, hstepB = (size_t)HALF * g.ldb * 2;
    const size_t tstepA = 2 * hstepA, tstepB = 2 * hstepB;
    const unsigned ldsw = (unsigned)wid * 1024u;
    const int aoff = lds_byte(wr * 64 + fr, fq * 8), boff = lds_byte(wc * 32 + fr, fq * 8);
#define PG8_SA(b, h) (((b) * 2 + (h)) * HTB)
#define PG8_SB(b, h) ((4 + (b) * 2 + (h)) * HTB)
#define PG8_STAGE(bufoff, gbase, voff) do { _Pragma("unroll") for (int _i = 0; _i < 2; ++_i) \
        __builtin_amdgcn_global_load_lds((const unsigned*)((const char*)(gbase) + (voff)[_i]), (LAS unsigned*)(lds + (bufoff) + ldsw + _i * 8192), 16, 0, 0); } while (0)
#define PG8_LDA(dst, b, h) do { _Pragma("unroll") for (int m = 0; m < 4; ++m) _Pragma("unroll") for (int k = 0; k < 2; ++k) dst[m][k] = *(const LAS bf16x8*)(lds + PG8_SA(b, h) + aoff + m * 2048 + k * 1024); } while (0)
#define PG8_LDB(dst, b, h) do { _Pragma("unroll") for (int n = 0; n < 2; ++n) _Pragma("unroll") for (int k = 0; k < 2; ++k) dst[n][k] = *(const LAS bf16x8*)(lds + PG8_SB(b, h) + boff + n * 2048 + k * 1024); } while (0)
#define PG8_MMA(ai, bj, At, Bt) do { __builtin_amdgcn_s_setprio(1); _Pragma("unroll") for (int m = 0; m < 4; ++m) _Pragma("unroll") for (int n = 0; n < 2; ++n) _Pragma("unroll") for (int k = 0; k < 2; ++k) \
        acc[ai][bj][m][n] = __builtin_amdgcn_mfma_f32_16x16x32_bf16(Bt[n][k], At[m][k], acc[ai][bj][m][n], 0, 0, 0); __builtin_amdgcn_s_setprio(0); } while (0)
#define PG8_WAIT_V(n) asm volatile("s_waitcnt vmcnt(" #n ")" ::: "memory")
#define PG8_WAIT_L(n) asm volatile("s_waitcnt lgkmcnt(" #n ")" ::: "memory")
#define PG8_BAR __builtin_amdgcn_s_barrier()
#define PG8_SCHED __builtin_amdgcn_sched_barrier(0)
    Unit cur, nxt; int ui = 0;
    if (!S.next(0, cur)) return;
    f32x4 acc[2][2][4][2];
#pragma unroll
    for (int a = 0; a < 2; ++a)
#pragma unroll
        for (int b = 0; b < 2; ++b)
#pragma unroll
            for (int m = 0; m < 4; ++m)
#pragma unroll
                for (int n = 0; n < 2; ++n) acc[a][b][m][n] = (f32x4){0.f, 0.f, 0.f, 0.f};
    bf16x8 At[4][2], B0[2][2], B1[2][2];
    const char* cA = (const char*)g.A + (size_t)cur.pm * tstepA; const char* cB = (const char*)g.Bt + (size_t)cur.pn * tstepB;
    PG8_STAGE(PG8_SB(0, 0), cB, voffB); PG8_STAGE(PG8_SB(0, 1), cB + hstepB, voffB); PG8_STAGE(PG8_SA(0, 0), cA, voffA); PG8_STAGE(PG8_SA(0, 1), cA + hstepA, voffA);
    if (wr == 1) PG8_BAR;
    PG8_WAIT_V(2); PG8_BAR;
    PG8_STAGE(PG8_SB(1, 0), cB + kstep, voffB); PG8_STAGE(PG8_SA(1, 0), cA + kstep, voffA); PG8_STAGE(PG8_SB(1, 1), cB + hstepB + kstep, voffB);
    PG8_WAIT_V(6); PG8_BAR;
    for (;;) {
        const bool has_next = S.next(ui + 1, nxt);
        const char* nA = has_next ? (const char*)g.A + (size_t)nxt.pm * tstepA : cA; const char* nB = has_next ? (const char*)g.Bt + (size_t)nxt.pn * tstepB : cB;
        for (int t = 0; t < nt; t += 2) {
            const bool last = (t == nt - 2);
            const char* a1 = cA + (size_t)(t + 1) * kstep;
            const char* a2 = last ? nA : cA + (size_t)(t + 2) * kstep; const char* b2 = last ? nB : cB + (size_t)(t + 2) * kstep;
            const char* a3 = a2 + kstep; const char* b3 = b2 + kstep;
            PG8_LDB(B0, 0, 0); PG8_LDB(B1, 0, 1); PG8_SCHED; PG8_LDA(At, 0, 0); PG8_STAGE(PG8_SA(1, 1), a1 + hstepA, voffA);
            PG8_WAIT_V(8); PG8_WAIT_L(0); PG8_BAR; PG8_MMA(0, 0, At, B0); PG8_MMA(0, 1, At, B1); PG8_BAR; PG8_SCHED;
            PG8_LDA(At, 0, 1); PG8_STAGE(PG8_SB(0, 0), b2, voffB); PG8_STAGE(PG8_SB(0, 1), b2 + hstepB, voffB); PG8_STAGE(PG8_SA(0, 0), a2, voffA);
            PG8_WAIT_V(8); PG8_WAIT_L(0); PG8_BAR; PG8_MMA(1, 0, At, B0); PG8_MMA(1, 1, At, B1); PG8_BAR; PG8_SCHED;
            PG8_LDB(B0, 1, 0); PG8_LDB(B1, 1, 1); PG8_SCHED; PG8_LDA(At, 1, 0); PG8_STAGE(PG8_SA(0, 1), a2 + hstepA, voffA);
            PG8_WAIT_V(8); PG8_WAIT_L(0); PG8_BAR; PG8_MMA(0, 0, At, B0); PG8_MMA(0, 1, At, B1); PG8_BAR; PG8_SCHED;
            PG8_LDA(At, 1, 1); PG8_STAGE(PG8_SB(1, 0), b3, voffB); PG8_STAGE(PG8_SB(1, 1), b3 + hstepB, voffB); PG8_STAGE(PG8_SA(1, 0), a3, voffA);
            PG8_WAIT_V(8); PG8_WAIT_L(0); PG8_BAR; PG8_MMA(1, 0, At, B0); PG8_MMA(1, 1, At, B1); PG8_BAR; PG8_SCHED;
        }
        if constexpr (ALIGN_EPI) { if (wr == 0) PG8_BAR; }
        E(acc, cur, wr, wc, fr, fq);
        if (!has_next) break;
#pragma unroll
        for (int a = 0; a < 2; ++a)
#pragma unroll
            for (int b = 0; b < 2; ++b)
#pragma unroll
                for (int m = 0; m < 4; ++m)
#pragma unroll
                    for (int n = 0; n < 2; ++n) acc[a][b][m][n] = (f32x4){0.f, 0.f, 0.f, 0.f};
        cur = nxt; cA = nA; cB = nB; ++ui;
        if constexpr (ALIGN_EPI) { if (wr == 1) PG8_BAR; }
    }
    PG8_WAIT_V(0);
    if constexpr (!ALIGN_EPI) { if (wr == 0) PG8_BAR; }
    PG8_BAR;
#undef PG8_SA
#undef PG8_SB
#undef PG8_STAGE
#undef PG8_LDA
#undef PG8_LDB
#undef PG8_MMA
#undef PG8_WAIT_V
#undef PG8_WAIT_L
#undef PG8_BAR
#undef PG8_SCHED
}

struct EpiInProj {
    static constexpr bool PERM = true;
    bf16_t* ZA; bf16_t* ZY; float* GLOW; const float* ROPE;
    __device__ __forceinline__ void operator()(const f32x4 (&acc)[2][2][4][2], const Unit& u, int wr, int wc, int fr, int fq) const {
        const int row0 = u.pm * BM + wr * 64 + fr;
        if (u.pn == 21) {
            if (wc == 0 && fq < 2) {
#pragma unroll
                for (int ai = 0; ai < 2; ++ai)
#pragma unroll
                    for (int m = 0; m < 4; ++m) { float* gp = GLOW + (size_t)(row0 + ai * HALF + m * 16) * 16 + 8 * fq;
                        *(f32x4*)gp = acc[ai][0][m][0]; *(f32x4*)(gp + 4) = acc[ai][0][m][1]; }
            }
            return;
        }
        bf16_t* base; int pitch, colt;
        if (u.pn < 13) { base = ZA; pitch = ZA_P; colt = u.pn * BM; } else { base = ZY; pitch = ZY_P; colt = (u.pn - 13) * BM; }
        const int col0 = colt + wc * 32 + 8 * fq;
        const bool rope_w = (u.pn <= 4) && ((wc & 1) == 0);
        const float sc = (u.pn < 4) ? QSCALE : 1.0f;
        const float sgn = (fq == 0) ? -1.0f : 1.0f;
#pragma unroll
        for (int ai = 0; ai < 2; ++ai)
#pragma unroll
            for (int m = 0; m < 4; ++m) {
                const int row = row0 + ai * HALF + m * 16;
                bf16_t* rowp = base + (size_t)row * pitch + col0;
                f32x4 c0 = (f32x4){1.f, 1.f, 1.f, 1.f}, c1 = c0, s0 = (f32x4){0.f, 0.f, 0.f, 0.f}, s1 = s0;
                if (rope_w) { const float* rp = ROPE + (size_t)row * 16; c0 = *(const f32x4*)rp; c1 = *(const f32x4*)(rp + 4); s0 = *(const f32x4*)(rp + 8); s1 = *(const f32x4*)(rp + 12); }
#pragma unroll
                for (int bj = 0; bj < 2; ++bj) {
                    f32x4 v0 = acc[ai][bj][m][0], v1 = acc[ai][bj][m][1];
                    if (rope_w && !(u.pn == 4 && bj == 1)) {
                        f32x4 o0, o1;
#pragma unroll
                        for (int e = 0; e < 4; ++e) { o0[e] = __shfl_xor(v0[e], 16); o1[e] = __shfl_xor(v1[e], 16); }
                        if (fq < 2) { v0 = v0 * c0 + (o0 * s0) * sgn; v1 = v1 * c1 + (o1 * s1) * sgn; }
                    }
                    v0 = v0 * sc; v1 = v1 * sc;
                    u32x4 w; w.x = cvt_pk_bf16(v0[0], v0[1]); w.y = cvt_pk_bf16(v0[2], v0[3]); w.z = cvt_pk_bf16(v1[0], v1[1]); w.w = cvt_pk_bf16(v1[2], v1[3]);
                    *(u32x4*)(rowp + bj * HALF) = w;
                }
            }
    }
};
struct EpiPlainBf16 {
    static constexpr bool PERM = true;
    bf16_t* O; int ldc;
    __device__ __forceinline__ void operator()(const f32x4 (&acc)[2][2][4][2], const Unit& u, int wr, int wc, int fr, int fq) const {
        const int row0 = u.pm * BM + wr * 64 + fr, col0 = u.pn * BM + wc * 32 + 8 * fq;
#pragma unroll
        for (int ai = 0; ai < 2; ++ai)
#pragma unroll
            for (int m = 0; m < 4; ++m) { bf16_t* rowp = O + (size_t)(row0 + ai * HALF + m * 16) * ldc + col0;
#pragma unroll
                for (int bj = 0; bj < 2; ++bj) { const f32x4 v0 = acc[ai][bj][m][0], v1 = acc[ai][bj][m][1];
                    u32x4 w; w.x = cvt_pk_bf16(v0[0], v0[1]); w.y = cvt_pk_bf16(v0[2], v0[3]); w.z = cvt_pk_bf16(v1[0], v1[1]); w.w = cvt_pk_bf16(v1[2], v1[3]);
                    *(u32x4*)(rowp + bj * HALF) = w; } }
    }
};
struct EpiOutProj {
    static constexpr bool PERM = false;
    const float* X; float* OUT; bf16_t* HB; const float* PN; float* RSS;
    __device__ __forceinline__ void operator()(const f32x4 (&acc)[2][2][4][2], const Unit& u, int wr, int wc, int fr, int fq) const {
        const int row0 = u.pm * BM + wr * 64 + fr, col0 = u.pn * BM + wc * 32 + 4 * fq;
        f32x4 pn[2][2];
#pragma unroll
        for (int bj = 0; bj < 2; ++bj)
#pragma unroll
            for (int n = 0; n < 2; ++n) pn[bj][n] = *(const f32x4*)(PN + col0 + bj * HALF + n * 16);
#pragma unroll
        for (int ai = 0; ai < 2; ++ai)
#pragma unroll
            for (int m = 0; m < 4; ++m) {
                const int row = row0 + ai * HALF + m * 16; const size_t off = (size_t)row * D_MODEL + col0; float ss = 0.f;
#pragma unroll
                for (int bj = 0; bj < 2; ++bj)
#pragma unroll
                    for (int n = 0; n < 2; ++n) {
                        const f32x4 xv = *(const f32x4*)(X + off + bj * HALF + n * 16);
                        const f32x4 h = acc[ai][bj][m][n] + xv;
                        *(f32x4*)(OUT + off + bj * HALF + n * 16) = h;
                        ss += (h[0] * h[0] + h[1] * h[1]) + (h[2] * h[2] + h[3] * h[3]);
                        const f32x4 hn = h * pn[bj][n];
                        u32x2 w; w.x = cvt_pk_bf16(hn[0], hn[1]); w.y = cvt_pk_bf16(hn[2], hn[3]);
                        *(u32x2*)(HB + off + bj * HALF + n * 16) = w;
                    }
                ss += __shfl_xor(ss, 16); ss += __shfl_xor(ss, 32);
                if (fq == 0) RSS[(size_t)row * 16 + u.pn * 4 + wc] = ss;
            }
    }
};
struct EpiGate {
    static constexpr bool PERM = false;
    float* OUT; const bf16_t* PP; const float* RSS1; float* RSS2;
    __device__ __forceinline__ void operator()(const f32x4 (&acc)[2][2][4][2], const Unit& u, int wr, int wc, int fr, int fq) const {
        const int row0 = u.pm * BM + wr * 64 + fr, col0 = u.pn * BM + wc * 32 + 4 * fq;
#pragma unroll
        for (int ai = 0; ai < 2; ++ai)
#pragma unroll
            for (int m = 0; m < 4; ++m) {
                const int row = row0 + ai * HALF + m * 16; const size_t off = (size_t)row * D_MODEL + col0;
                const f32x4* rp = (const f32x4*)(RSS1 + (size_t)row * 16);
                const f32x4 r0 = rp[0], r1 = rp[1], r2 = rp[2], r3 = rp[3];
                const f32x4 rs = (r0 + r1) + (r2 + r3);
                const float r = __builtin_amdgcn_rsqf(((rs[0] + rs[1]) + (rs[2] + rs[3])) * (1.0f / D_MODEL) + EPS);
                float ss = 0.f;
#pragma unroll
                for (int bj = 0; bj < 2; ++bj)
#pragma unroll
                    for (int n = 0; n < 2; ++n) {
                        const f32x4 hv = *(const f32x4*)(OUT + off + bj * HALF + n * 16);
                        const u32x2 pw = *(const u32x2*)(PP + off + bj * HALF + n * 16);
                        const f32x4 a = acc[ai][bj][m][n] * r;
                        f32x4 h2;
                        h2[0] = hv[0] + sigmoid_f(a[0]) * bflo(pw.x); h2[1] = hv[1] + sigmoid_f(a[1]) * bfhi(pw.x);
                        h2[2] = hv[2] + sigmoid_f(a[2]) * bflo(pw.y); h2[3] = hv[3] + sigmoid_f(a[3]) * bfhi(pw.y);
                        *(f32x4*)(OUT + off + bj * HALF + n * 16) = h2;
                        ss += (h2[0] * h2[0] + h2[1] * h2[1]) + (h2[2] * h2[2] + h2[3] * h2[3]);
                    }
                ss += __shfl_xor(ss, 16); ss += __shfl_xor(ss, 32);
                if (fq == 0) RSS2[(size_t)row * 16 + u.pn * 4 + wc] = ss;
            }
    }
};
}

#define XB_TMO      128
#define XB_XCNT(j)  (256  + 64 * (j))
#define XB_XSUB(j)  (1280 + 64 * (j))
#define XB_XGEN(j)  (2304 + 64 * (j))
#define XB_TOP      3328
#define XB_TOPGEN   3392
#define XCD_BAR_WORDS 3456
#define XB_SPIN_CAP (1u << 18)
__device__ __forceinline__ unsigned xb_ld(unsigned* p)              { return __hip_atomic_load(p, __ATOMIC_RELAXED, __HIP_MEMORY_SCOPE_AGENT); }
__device__ __forceinline__ unsigned xb_add(unsigned* p, unsigned v) { return __hip_atomic_fetch_add(p, v, __ATOMIC_RELAXED, __HIP_MEMORY_SCOPE_AGENT); }
__device__ __forceinline__ unsigned xb_xcc_id() { return (unsigned)__builtin_amdgcn_s_getreg((3 << 11) | 20) & 0xFu; }
#define XB_SPIN(cond, bar) do { unsigned _sp = 0; while (cond) { __builtin_amdgcn_s_sleep(1); \
    if ((++_sp & 255u) == 0u) { if (xb_ld(&(bar)[XB_TMO])) break; if (_sp > XB_SPIN_CAP) { atomicAdd(&(bar)[XB_TMO], 1u); break; } } } } while (0)
struct XcdBarrier { unsigned* bar; unsigned x; volatile LAS unsigned* st; };
__device__ __forceinline__ XcdBarrier xcd_barrier_post(unsigned* bar, volatile LAS unsigned* st) {
    XcdBarrier b; b.bar = bar; b.x = xb_xcc_id(); b.st = st;
    if (threadIdx.x == 0) (void)xb_add(&bar[XB_XCNT(b.x)], 1u);
    return b;
}
__device__ __forceinline__ void xcd_barrier_complete(unsigned* bar, unsigned x, unsigned& nloc, unsigned& nx) {
    const unsigned G = gridDim.x * gridDim.y * gridDim.z;
    unsigned sum, cnt, mine, sp = 0u;
    for (;;) {
        sum = 0u; cnt = 0u; mine = 0u;
#pragma unroll
        for (unsigned j = 0; j < 16; ++j) { const unsigned c = xb_ld(&bar[XB_XCNT(j)]); sum += c; cnt += (c > 0u) ? 1u : 0u; mine = (j == x) ? c : mine; }
        if (sum == G) break;
        __builtin_amdgcn_s_sleep(1);
        if ((++sp & 255u) == 0u) { if (xb_ld(&bar[XB_TMO])) break; if (sp > XB_SPIN_CAP) { atomicAdd(&bar[XB_TMO], 1u); break; } }
    }
    nloc = mine > 0u ? mine : 1u; nx = cnt > 0u ? cnt : 1u;
}
__device__ __forceinline__ void xcd_barrier(const XcdBarrier& b) {
    asm volatile("s_waitcnt vmcnt(0)" ::: "memory");
    __syncthreads();
    if (threadIdx.x == 0) {
        unsigned* bar = b.bar;
        __builtin_amdgcn_s_waitcnt(0);
        unsigned nloc = b.st[0], nx = b.st[1];
        if (nloc == 0u) { xcd_barrier_complete(bar, b.x, nloc, nx); b.st[0] = nloc; b.st[1] = nx; }
        const unsigned old = xb_add(&bar[XB_XSUB(b.x)], 1u);
        const unsigned gen = old / nloc;
        if (old + 1u == (gen + 1u) * nloc) {
            __builtin_amdgcn_fence(__ATOMIC_RELEASE, "agent");
            asm volatile("s_waitcnt vmcnt(0)" ::: "memory");
            const unsigned og = xb_add(&bar[XB_TOP], 1u);
            const unsigned tg = og / nx;
            if (og + 1u == (tg + 1u) * nx) xb_add(&bar[XB_TOPGEN], 1u);
            else XB_SPIN(xb_ld(&bar[XB_TOPGEN]) == tg, bar);
            __builtin_amdgcn_fence(__ATOMIC_ACQUIRE, "agent");
            xb_add(&bar[XB_XGEN(b.x)], 1u);
            asm volatile("s_waitcnt vmcnt(0)" ::: "memory");
        } else {
            XB_SPIN(xb_ld(&bar[XB_XGEN(b.x)]) == gen, bar);
            __builtin_amdgcn_fence(__ATOMIC_ACQUIRE, "agent");
            asm volatile("s_waitcnt vmcnt(0)" ::: "memory");
        }
    }
    __syncthreads();
}

__device__ __forceinline__ float wave_sum(float v) {
#pragma unroll
    for (int o = 1; o < 64; o <<= 1) v += __shfl_xor(v, o);
    return v;
}
namespace att {
typedef short v4i16_t __attribute__((ext_vector_type(4)));
constexpr int LDS_K = 0, LDS_V = 32768, LDS_WS = 65536, LDS_ST = LDS_WS + 8 * 256, LDS_TOTAL = LDS_ST + 8 * 4096;
__device__ __forceinline__ int crow(int r, int hi) { return (r & 3) + 8 * (r >> 2) + 4 * hi; }
__device__ __forceinline__ float swapmax(float m) { auto rr = __builtin_amdgcn_permlane32_swap(__float_as_uint(m), __float_as_uint(m), false, false); return fmaxf(__uint_as_float(rr[0]), __uint_as_float(rr[1])); }
__device__ __forceinline__ float swapsum(float m) { auto rr = __builtin_amdgcn_permlane32_swap(__float_as_uint(m), __float_as_uint(m), false, false); return __uint_as_float(rr[0]) + __uint_as_float(rr[1]); }
__device__ __forceinline__ bf16x8 trpair(LAS unsigned char* p) {
    const v4i16_t lo = __builtin_amdgcn_ds_read_tr16_b64_v4i16((LAS v4i16_t*)p);
    const v4i16_t hi = __builtin_amdgcn_ds_read_tr16_b64_v4i16((LAS v4i16_t*)(p + 512));
    return (bf16x8){lo[0], lo[1], lo[2], lo[3], hi[0], hi[1], hi[2], hi[3]};
}

__device__ __forceinline__ void attn_unit(LAS unsigned char* lds, int b, int kvh, int qb, const bf16_t* ZA, bf16_t* ZY, const float* sinks) {
    const int tid = threadIdx.x, lane = tid & 63, r32 = lane & 31, hi = lane >> 5, wid = __builtin_amdgcn_readfirstlane(tid >> 6);
    const int h = kvh * 8 + wid;
    const size_t tok0 = (size_t)b * SEQ + (size_t)qb * 128;
#pragma unroll
    for (int i = 0; i < 4; ++i) {
        const int id = tid + 512 * i, key = id >> 3, c = id & 7, pos = qb * 128 - 128 + key;
        u32x4 kv = (u32x4){0u, 0u, 0u, 0u}, vv = kv;
        if (pos >= 0) { const bf16_t* row = ZA + ((size_t)b * SEQ + pos) * ZA_P; kv = *(const u32x4*)(row + C_AK + kvh * HD + c * 8); vv = *(const u32x4*)(row + C_AV + kvh * HD + c * 8); }
        *(LAS u32x4*)(lds + LDS_K + c * 4096 + key * 16) = kv;
        *(LAS u32x4*)(lds + LDS_V + (c >> 2) * 16384 + key * 64 + (c & 3) * 16) = vv;
    }
    __syncthreads();
    const float sink2 = sinks[h] * LOG2E;
    LAS float* wsf = (LAS float*)(lds + LDS_WS) + wid * 64;
    LAS bf16_t* stg = (LAS bf16_t*)(lds + LDS_ST) + wid * 2048;
    const int vlane = ((lane >> 4) & 1) * 32 + (lane & 3) * 8 + (4 * hi + ((lane & 15) >> 2)) * 64;
    for (int s = 0; s < 4; ++s) {
        bf16x8 qr[4];
        { const bf16_t* qp = ZA + (tok0 + 32 * s + r32) * ZA_P + C_AQ + h * HD + 8 * hi;
#pragma unroll
          for (int d0 = 0; d0 < 4; ++d0) qr[d0] = *(const bf16x8*)(qp + 16 * d0); }
        f32x16 p[5];
#pragma unroll
        for (int t = 0; t < 5; ++t) {
            const LAS unsigned char* kb = lds + LDS_K + hi * 4096 + (32 * (s + t) + r32) * 16;
#pragma unroll
            for (int d0 = 0; d0 < 4; ++d0) {
                const bf16x8 a = *(const LAS bf16x8*)(kb + d0 * 8192);
                if (d0 == 0) p[t] = __builtin_amdgcn_mfma_f32_32x32x16_bf16(a, qr[0], (f32x16){0.f, 0.f, 0.f, 0.f, 0.f, 0.f, 0.f, 0.f, 0.f, 0.f, 0.f, 0.f, 0.f, 0.f, 0.f, 0.f}, 0, 0, 0);
                else p[t] = __builtin_amdgcn_mfma_f32_32x32x16_bf16(a, qr[d0], p[t], 0, 0, 0);
            }
        }
#pragma unroll
        for (int r = 0; r < 16; ++r) { const int c = crow(r, hi); if (c <= r32) p[0][r] = -INFINITY; if (c > r32) p[4][r] = -INFINITY; }
        if (qb == 0) {
#pragma unroll
            for (int t = 0; t < 5; ++t) if (s + t < 4) {
#pragma unroll
                for (int r = 0; r < 16; ++r) p[t][r] = -INFINITY; }
        }
        float m = sink2;
#pragma unroll
        for (int t = 0; t < 5; ++t)
#pragma unroll
            for (int r = 0; r < 16; ++r) m = fmaxf(m, p[t][r]);
        m = swapmax(m);
        float l = 0.f;
#pragma unroll
        for (int t = 0; t < 5; ++t)
#pragma unroll
            for (int r = 0; r < 16; ++r) { p[t][r] = fast_exp2(p[t][r] - m); l += p[t][r]; }
        l = swapsum(l) + fast_exp2(sink2 - m);
        f32x16 o[2];
        o[0] = (f32x16){0.f, 0.f, 0.f, 0.f, 0.f, 0.f, 0.f, 0.f, 0.f, 0.f, 0.f, 0.f, 0.f, 0.f, 0.f, 0.f}; o[1] = o[0];
#pragma unroll
        for (int t = 0; t < 5; ++t)
#pragma unroll
            for (int k2 = 0; k2 < 2; ++k2) {
                u32x4 pw; pw.x = cvt_pk_bf16(p[t][8 * k2 + 0], p[t][8 * k2 + 1]); pw.y = cvt_pk_bf16(p[t][8 * k2 + 2], p[t][8 * k2 + 3]);
                pw.z = cvt_pk_bf16(p[t][8 * k2 + 4], p[t][8 * k2 + 5]); pw.w = cvt_pk_bf16(p[t][8 * k2 + 6], p[t][8 * k2 + 7]);
                const bf16x8 pa = __builtin_bit_cast(bf16x8, pw);
                LAS unsigned char* vb = lds + LDS_V + (32 * (s + t) + 16 * k2) * 64 + vlane;
                const bf16x8 v0 = trpair(vb), v1 = trpair(vb + 16384);
                o[0] = __builtin_amdgcn_mfma_f32_32x32x16_bf16(pa, v0, o[0], 0, 0, 0);
                o[1] = __builtin_amdgcn_mfma_f32_32x32x16_bf16(pa, v1, o[1], 0, 0, 0);
            }
        if (hi == 0) wsf[r32] = fast_rcp(l);
        LDS_WAIT();
#pragma unroll
        for (int r = 0; r < 16; ++r) { const int q = crow(r, hi); const float rl = wsf[q];
            stg[q * 64 + r32] = (bf16_t)f2bf(o[0][r] * rl); stg[q * 64 + 32 + r32] = (bf16_t)f2bf(o[1][r] * rl); }
        LDS_WAIT();
#pragma unroll
        for (int i = 0; i < 4; ++i) {
            const int row = i * 8 + (lane >> 3), ch = lane & 7;
            const u32x4 ov = *(const LAS u32x4*)(stg + row * 64 + ch * 8);
            bf16_t* yp = ZY + (tok0 + 32 * s + row) * ZY_P + h * HD + ch * 8;
            const u32x4 zv = *(const u32x4*)yp;
            u32x4 w;
            w.x = cvt_pk_bf16(bflo(ov.x) * silu_f(bflo(zv.x)), bfhi(ov.x) * silu_f(bfhi(zv.x)));
            w.y = cvt_pk_bf16(bflo(ov.y) * silu_f(bflo(zv.y)), bfhi(ov.y) * silu_f(bfhi(zv.y)));
            w.z = cvt_pk_bf16(bflo(ov.z) * silu_f(bflo(zv.z)), bfhi(ov.z) * silu_f(bfhi(zv.z)));
            w.w = cvt_pk_bf16(bflo(ov.w) * silu_f(bflo(zv.w)), bfhi(ov.w) * silu_f(bfhi(zv.w)));
            *(u32x4*)yp = w;
        }
        LDS_WAIT();
    }
    __syncthreads();
}
}
namespace gla {
typedef short v4i16_t __attribute__((ext_vector_type(4)));
constexpr int L_GL = 0, L_GT = 4096, L_DEC = 6144, L_QD = 8192, PQ = 272, L_KI = L_QD + 64 * PQ, L_KT = L_KI + 64 * PQ, PT = 320, L_V = L_KT + 64 * PT, PVB = 576, L_END = L_V + 64 * PVB;
constexpr int L_OST = L_QD, PO = 1040;
static_assert(L_END <= RING_BYTES && L_OST + 64 * PO <= L_END, "gla LDS map");
constexpr float QK_SCALE = 0.08838834764831845f;
__device__ __forceinline__ int crow(int r, int hi) { return (r & 3) + 8 * (r >> 2) + 4 * hi; }
__device__ __forceinline__ f32x16 zero16() { return (f32x16){0.f, 0.f, 0.f, 0.f, 0.f, 0.f, 0.f, 0.f, 0.f, 0.f, 0.f, 0.f, 0.f, 0.f, 0.f, 0.f}; }
__device__ __forceinline__ bf16x8 tr_frag(LAS unsigned char* p, int delta_bytes) {
    const v4i16_t lo = __builtin_amdgcn_ds_read_tr16_b64_v4i16((LAS v4i16_t*)p);
    const v4i16_t hi = __builtin_amdgcn_ds_read_tr16_b64_v4i16((LAS v4i16_t*)(p + delta_bytes));
    return (bf16x8){lo[0], lo[1], lo[2], lo[3], hi[0], hi[1], hi[2], hi[3]};
}
#define GLA_PACK8(v, b0) __builtin_bit_cast(bf16x8, (u32x4){cvt_pk_bf16_c((v)[(b0) + 0], (v)[(b0) + 1]), cvt_pk_bf16_c((v)[(b0) + 2], (v)[(b0) + 3]), cvt_pk_bf16_c((v)[(b0) + 4], (v)[(b0) + 5]), cvt_pk_bf16_c((v)[(b0) + 6], (v)[(b0) + 7])})

template <bool OUT>
__device__ __forceinline__ void gla_unit(LAS unsigned char* lds, int u, const bf16_t* ZA, bf16_t* ZY, const float* GLOW, const float* w_gate_up, const float* b_gate,
                                         const float* gla_norm, float* LST, float* DTOT) {
    const int tid = threadIdx.x, lane = tid & 63, r32 = lane & 31, hi = lane >> 5, wid = __builtin_amdgcn_readfirstlane(tid >> 6);
    const int b = u >> 7, h = (u >> 5) & 3, sc = u & 31;
    const size_t tok_u = (size_t)b * SEQ + (size_t)sc * 256;
    const int d = tid & 127, tg = tid >> 7;
    float wcol[16];
#pragma unroll
    for (int r = 0; r < 16; ++r) wcol[r] = w_gate_up[r * 512 + h * GLA_K + d];
    const float bg = b_gate[h * GLA_K + d];
    f32x16 S[4];
    if (OUT) {
#pragma unroll
        for (int kt = 0; kt < 4; ++kt)
#pragma unroll
            for (int r = 0; r < 16; ++r) S[kt][r] = LST[((size_t)u * 128 + 32 * kt + crow(r, hi)) * 256 + 32 * wid + r32];
    } else {
#pragma unroll
        for (int kt = 0; kt < 4; ++kt) S[kt] = zero16();
    }
    float bsum = 0.f;
    LAS float* GLs = (LAS float*)(lds + L_GL); LAS float* GT = (LAS float*)(lds + L_GT); LAS float* DEC = (LAS float*)(lds + L_DEC);
    const int trl = ((lane >> 4) & 1) * 32 + (lane & 3) * 8;
    const int trr = (lane & 15) >> 2;
    for (int c = 0; c < 4; ++c) {
        const size_t tok = tok_u + 64 * c;
        if (tid < 256) *(LAS f32x4*)(GLs + tid * 4) = *(const f32x4*)(GLOW + (tok + (tid >> 2)) * 16 + (tid & 3) * 4);
#pragma unroll
        for (int i = 0; i < 4; ++i) { const int id = tid + 512 * i, row = id >> 5, pc = id & 31;
            *(LAS u32x4*)(lds + L_V + row * PVB + pc * 16) = *(const u32x4*)(ZA + (tok + row) * ZA_P + C_GV + h * GLA_V + pc * 8); }
#pragma unroll
        for (int i = 0; i < 2; ++i) { const int id = tid + 512 * i, row = id >> 4, pc = id & 15; const bf16_t* zr = ZA + (tok + row) * ZA_P + h * GLA_K + pc * 8;
            *(LAS u32x4*)(lds + L_QD + row * 256 + pc * 16) = *(const u32x4*)(zr + C_GK);
            if (OUT) *(LAS u32x4*)(lds + L_KI + row * 256 + pc * 16) = *(const u32x4*)(zr + C_GQ); }
        __syncthreads();
        unsigned kqv[16];
#pragma unroll
        for (int i = 0; i < 16; ++i) { const int t = 16 * tg + i;
            kqv[i] = (unsigned)*(const LAS bf16_t*)(lds + L_QD + t * 256 + d * 2) | (OUT ? ((unsigned)*(const LAS bf16_t*)(lds + L_KI + t * 256 + d * 2) << 16) : 0u); }
        float bl[16]; float run = 0.f;
#pragma unroll
        for (int i = 0; i < 16; ++i) {
            const LAS f32x4* gp = (const LAS f32x4*)(GLs + (16 * tg + i) * 16);
            const f32x4 g0 = gp[0], g1 = gp[1], g2 = gp[2], g3 = gp[3];
            float xx = bg;
            xx += g0[0] * wcol[0] + g0[1] * wcol[1] + g0[2] * wcol[2] + g0[3] * wcol[3];
            xx += g1[0] * wcol[4] + g1[1] * wcol[5] + g1[2] * wcol[6] + g1[3] * wcol[7];
            xx += g2[0] * wcol[8] + g2[1] * wcol[9] + g2[2] * wcol[10] + g2[3] * wcol[11];
            xx += g3[0] * wcol[12] + g3[1] * wcol[13] + g3[2] * wcol[14] + g3[3] * wcol[15];
            const float e = fast_exp2(-fabsf(xx) * LOG2E);
            const float lg2 = (fminf(xx, 0.f) * LOG2E - __builtin_amdgcn_logf(1.0f + e)) * (1.0f / 16.0f);
            run += lg2; bl[i] = run;
            if ((i & 3) == 3) __builtin_amdgcn_sched_barrier(0);
        }
        GT[tg * 128 + d] = run;
        __syncthreads();
        {
            const float t0 = GT[d], t1 = GT[128 + d], t2 = GT[256 + d], t3 = GT[384 + d];
            const float off = (tg > 0 ? t0 : 0.f) + (tg > 1 ? t1 : 0.f) + (tg > 2 ? t2 : 0.f);
            const float btot = (t0 + t1) + (t2 + t3);
#pragma unroll
            for (int i = 0; i < 16; ++i) {
                const float bb = off + bl[i]; const int t = 16 * tg + i;
                if (OUT) {
                    *(LAS bf16_t*)(lds + L_QD + t * PQ + d * 2) = (bf16_t)f2bf(bfhi(kqv[i]) * QK_SCALE * fast_exp2(bb));
                    *(LAS bf16_t*)(lds + L_KI + t * PQ + d * 2) = (bf16_t)f2bf(bflo(kqv[i]) * fast_exp2(-bb));
                }
                *(LAS bf16_t*)(lds + L_KT + t * PT + d * 2) = (bf16_t)f2bf(bflo(kqv[i]) * fast_exp2(btot - bb));
            }
            if (tg == 0) { DEC[d] = fast_exp2(btot); bsum += btot; }
        }
        __syncthreads();
        __builtin_amdgcn_sched_barrier(0);
        f32x16 o[2];
        if (OUT) {
            o[0] = zero16(); o[1] = zero16();
#pragma unroll
            for (int kt = 0; kt < 4; ++kt)
#pragma unroll
                for (int s = 0; s < 2; ++s) {
                    const bf16x8 sb = GLA_PACK8(S[kt], 8 * s);
#pragma unroll
                    for (int it = 0; it < 2; ++it) {
                        const LAS unsigned char* ap = lds + L_QD + (32 * it + r32) * PQ + (32 * kt + 16 * s + 4 * hi) * 2;
                        const u32x2 a0 = *(const LAS u32x2*)ap, a1 = *(const LAS u32x2*)(ap + 16);
                        const bf16x8 a = __builtin_bit_cast(bf16x8, (u32x4){a0.x, a0.y, a1.x, a1.y});
                        o[it] = __builtin_amdgcn_mfma_f32_32x32x16_bf16(a, sb, o[it], 0, 0, 0);
                    }
                    __builtin_amdgcn_sched_barrier(0);
                }
            __builtin_amdgcn_sched_barrier(0);
#pragma unroll
            for (int pair = 0; pair < 3; ++pair) {
                const int jt = (pair == 2) ? 1 : 0, it = (pair == 0) ? 0 : 1;
                f32x16 X = zero16();
#pragma unroll
                for (int ks = 0; ks < 8; ++ks) {
                    const bf16x8 a = *(const LAS bf16x8*)(lds + L_KI + (32 * jt + r32) * PQ + (16 * ks + 8 * hi) * 2);
                    const bf16x8 bq = *(const LAS bf16x8*)(lds + L_QD + (32 * it + r32) * PQ + (16 * ks + 8 * hi) * 2);
                    X = __builtin_amdgcn_mfma_f32_32x32x16_bf16(a, bq, X, 0, 0, 0);
                    if (ks & 1) __builtin_amdgcn_sched_barrier(0);
                }
                if (jt == it) {
#pragma unroll
                    for (int r = 0; r < 16; ++r) if (crow(r, hi) > r32) X[r] = 0.f;
                }
#pragma unroll
                for (int s = 0; s < 2; ++s) {
                    const bf16x8 xa = GLA_PACK8(X, 8 * s);
                    const bf16x8 vb = tr_frag(lds + L_V + (32 * jt + 16 * s + 4 * hi + trr) * PVB + wid * 64 + trl, 8 * PVB);
                    o[it] = __builtin_amdgcn_mfma_f32_32x32x16_bf16(xa, vb, o[it], 0, 0, 0);
                }
            }
        }
        __builtin_amdgcn_sched_barrier(0);
#pragma unroll
        for (int kt = 0; kt < 4; ++kt) {
#pragma unroll
            for (int g = 0; g < 4; ++g) { const f32x4 dv4 = *(const LAS f32x4*)(DEC + 32 * kt + 8 * g + 4 * hi);
                S[kt][4 * g + 0] *= dv4[0]; S[kt][4 * g + 1] *= dv4[1]; S[kt][4 * g + 2] *= dv4[2]; S[kt][4 * g + 3] *= dv4[3]; }
        }
#pragma unroll
        for (int s = 0; s < 4; ++s) {
            const bf16x8 vb = tr_frag(lds + L_V + (16 * s + 8 * hi + trr) * PVB + wid * 64 + trl, 4 * PVB);
#pragma unroll
            for (int kt = 0; kt < 4; ++kt) {
                const bf16x8 ka = tr_frag(lds + L_KT + (16 * s + 8 * hi + trr) * PT + kt * 64 + trl, 4 * PT);
                S[kt] = __builtin_amdgcn_mfma_f32_32x32x16_bf16(ka, vb, S[kt], 0, 0, 0);
            }
        }
        __syncthreads();
        if (OUT) {
#pragma unroll
            for (int it = 0; it < 2; ++it)
#pragma unroll
                for (int r = 0; r < 16; ++r) *(LAS float*)(lds + L_OST + (32 * it + crow(r, hi)) * PO + (32 * wid + r32) * 4) = o[it][r];
            __syncthreads();
            {
                const int token = tid >> 3, pc = tid & 7;
                const LAS f32x4* op = (const LAS f32x4*)(lds + L_OST + token * PO + pc * 128);
                f32x4 ov[8]; float ss = 0.f;
#pragma unroll
                for (int q = 0; q < 8; ++q) { ov[q] = op[q]; ss += (ov[q][0] * ov[q][0] + ov[q][1] * ov[q][1]) + (ov[q][2] * ov[q][2] + ov[q][3] * ov[q][3]); }
                ss += __shfl_xor(ss, 1); ss += __shfl_xor(ss, 2); ss += __shfl_xor(ss, 4);
                const float rstd = __builtin_amdgcn_rsqf(ss * (1.0f / GLA_V) + EPS);
                bf16_t* yp = ZY + (tok + token) * ZY_P + 1024 + h * GLA_V + pc * 32;
                const f32x4* gn = (const f32x4*)(gla_norm + pc * 32);
#pragma unroll
                for (int q = 0; q < 4; ++q) {
                    const u32x4 zv = *(const u32x4*)(yp + q * 8);
                    const f32x4 ga = gn[2 * q], gb = gn[2 * q + 1]; const f32x4 oa = ov[2 * q] * rstd * ga, ob = ov[2 * q + 1] * rstd * gb;
                    u32x4 w;
                    w.x = cvt_pk_bf16_c(oa[0] * silu_f(bflo(zv.x)), oa[1] * silu_f(bfhi(zv.x)));
                    w.y = cvt_pk_bf16_c(oa[2] * silu_f(bflo(zv.y)), oa[3] * silu_f(bfhi(zv.y)));
                    w.z = cvt_pk_bf16_c(ob[0] * silu_f(bflo(zv.z)), ob[1] * silu_f(bfhi(zv.z)));
                    w.w = cvt_pk_bf16_c(ob[2] * silu_f(bflo(zv.w)), ob[3] * silu_f(bfhi(zv.w)));
                    *(u32x4*)(yp + q * 8) = w;
                }
            }
            __syncthreads();
        }
    }
    if (!OUT) {
#pragma unroll
        for (int kt = 0; kt < 4; ++kt)
#pragma unroll
            for (int r = 0; r < 16; ++r) LST[((size_t)u * 128 + 32 * kt + crow(r, hi)) * 256 + 32 * wid + r32] = S[kt][r];
        if (tg == 0) DTOT[u * 128 + d] = fast_exp2(bsum);
    }
}
#undef GLA_PACK8

__device__ __forceinline__ void gla_scan(int gt, int NT, float* LST, const float* DTOT) {
    for (int e = gt; e < 8 * 8192; e += NT) {
        const int bh = e >> 13, idx4 = e & 8191, dk = idx4 >> 6;
        f32x4 carry = (f32x4){0.f, 0.f, 0.f, 0.f};
        f32x4* p = (f32x4*)(LST + (size_t)bh * 32 * 32768) + idx4;
        const float* dp = DTOT + bh * 32 * 128 + dk;
#pragma unroll 8
        for (int sc = 0; sc < 32; ++sc) { const f32x4 t = p[(size_t)sc * 8192]; const float dd = dp[sc * 128]; p[(size_t)sc * 8192] = carry; carry = carry * dd + t; }
    }
}
}
__device__ __forceinline__ void p0_transpose_item(const float* W, int K, int Nsrc, bf16_t* WT, int k0, int n0, int src0, int nvalid, LAS float* scr, int lane) {
    const bool ok = (lane & 31) < nvalid;
#pragma unroll 8
    for (int i = 0; i < 32; ++i) { const int kk = 2 * i + (lane >> 5); scr[kk * 33 + (lane & 31)] = ok ? W[(size_t)(k0 + kk) * Nsrc + src0 + (lane & 31)] : 0.f; }
    LDS_WAIT(); asm volatile("" ::: "memory");
    const int c = lane & 7;
#pragma unroll
    for (int j = 0; j < 4; ++j) { const int n = (lane >> 3) + 8 * j; const LAS float* s = scr + (8 * c) * 33 + n;
        u32x4 o; o.x = pk2(s[0 * 33], s[1 * 33]); o.y = pk2(s[2 * 33], s[3 * 33]); o.z = pk2(s[4 * 33], s[5 * 33]); o.w = pk2(s[6 * 33], s[7 * 33]);
        *(u32x4*)(WT + (size_t)(n0 + n) * K + k0 + 8 * c) = o; }
    LDS_WAIT(); asm volatile("" ::: "memory");
}
__device__ __forceinline__ void rms_row_to_bf16(const float* xrow, const float* g, bf16_t* orow, int lane) {
    const f32x4* xr = (const f32x4*)xrow + lane; const f32x4* gr = (const f32x4*)g + lane;
    f32x4 v[4]; float s = 0.f;
#pragma unroll
    for (int j = 0; j < 4; ++j) { v[j] = xr[64 * j]; s += (v[j][0] * v[j][0] + v[j][1] * v[j][1]) + (v[j][2] * v[j][2] + v[j][3] * v[j][3]); }
    const float r = 1.0f / sqrtf(wave_sum(s) * (1.f / D_MODEL) + EPS);
    unsigned long long* o8 = (unsigned long long*)orow + lane;
#pragma unroll
    for (int j = 0; j < 4; ++j) { const f32x4 gg = gr[64 * j]; const f32x4 y = v[j] * r * gg;
        o8[64 * j] = (unsigned long long)pk2(y[0], y[1]) | ((unsigned long long)pk2(y[2], y[3]) << 32); }
}

struct Args { const void* in[14]; float* out; unsigned char* ws; int ph_lo, ph_hi, li, pad; };

__global__ void __launch_bounds__(NWAVES * 64, 2) mk_fwd(Args args) {
    extern __shared__ __attribute__((aligned(16))) unsigned char lds_raw[];
    LAS unsigned char* lds = (LAS unsigned char*)lds_raw;
    volatile LAS unsigned* MISC = (volatile LAS unsigned*)(lds + MISC_OFF);
    const int tid = threadIdx.x, lane = tid & 63, wave = __builtin_amdgcn_readfirstlane(tid >> 6);
    const int G = gridDim.x, bx = blockIdx.x;
    const int vcu = (G % 8 == 0) ? (bx % 8) * (G / 8) + bx / 8 : bx;
    unsigned char* ws = args.ws;
    unsigned* ctl = (unsigned*)(ws + WS_CTL);
    const float* x = (const float*)args.in[0]; const float* p = (const float*)args.in[1]; const int* positions = (const int*)args.in[2];
    const float* norm_mix = (const float*)args.in[3]; const float* w_in = (const float*)args.in[4]; const float* sinks = (const float*)args.in[5];
    const float* w_gate_up = (const float*)args.in[6]; const float* b_gate = (const float*)args.in[7]; const float* gla_norm = (const float*)args.in[8];
    const float* w_out = (const float*)args.in[9]; const float* ple_norm = (const float*)args.in[10]; const float* w_ple_gate = (const float*)args.in[11];
    const float* w_ple_proj = (const float*)args.in[12]; const float* final_norm = (const float*)args.in[13];
    float* out = args.out;
    bf16_t* WIN = (bf16_t*)(ws + WS_WIN); bf16_t* WOUT = (bf16_t*)(ws + WS_WOUT); bf16_t* WG = (bf16_t*)(ws + WS_WG); bf16_t* WP = (bf16_t*)(ws + WS_WP);
    float* ROPE = (float*)(ws + WS_ROPE); float* GLOW = (float*)(ws + WS_GLOW); float* RSS1 = (float*)(ws + WS_RSS1); float* RSS2 = (float*)(ws + WS_RSS2);
    bf16_t* XN = (bf16_t*)(ws + WS_XN); bf16_t* ZA = (bf16_t*)(ws + WS_ZA); bf16_t* ZY = (bf16_t*)(ws + WS_ZY); bf16_t* HB = (bf16_t*)(ws + WS_HB); bf16_t* PP = (bf16_t*)(ws + WS_PP);
    bf16_t* PB = (bf16_t*)out;
    float* LST = (float*)(ws + WS_XN); float* DTOT = (float*)(ws + WS_GLAD);

    for (int u = tid; u < (LDS_BYTES - LDSCTL_OFF) / 4; u += NWAVES * 64) ((LAS unsigned*)(lds + LDSCTL_OFF))[u] = 0u;
    __syncthreads();
    XcdBarrier bar = xcd_barrier_post(ctl + CW_BAR + args.li * XCD_BAR_WORDS, MISC + 8);
    const int lo = args.ph_lo, hi = args.ph_hi;
#define IN(k) (lo <= (k) && (k) < hi)
#define BOTH(k) (IN(k) && IN((k) + 1))
    const int gw = vcu * NWAVES + wave, NGW = G * NWAVES;

    if (IN(0)) {
        LAS float* scr = (LAS float*)(lds + wave * 16384);
        constexpr int NB_IN = 169;
        constexpr int I_IN = 16 * NB_IN, I_OUT = 32 * 32, I_G = 16 * 32, I_P = 4 * 32, NITEMS = I_IN + I_OUT + I_G + I_P;
        for (int it = gw; it < NITEMS; it += NGW) {
            int r = it;
            if (r < I_IN) { const int kb = r / NB_IN, nb = r % NB_IN, n0 = 32 * nb;
                int src0, nv; if (n0 < 3328) { src0 = n0; nv = 32; } else if (n0 < 5376) { src0 = n0 + 16; nv = 32; } else { src0 = 3328; nv = 16; }
                p0_transpose_item(w_in, D_MODEL, NZ_SRC, WIN, 64 * kb, n0, src0, nv, scr, lane); continue; }
            r -= I_IN;
            if (r < I_OUT) { p0_transpose_item(w_out, D_MIX, D_MODEL, WOUT, 64 * (r / 32), 32 * (r % 32), 32 * (r % 32), 32, scr, lane); continue; }
            r -= I_OUT;
            if (r < I_G) { p0_transpose_item(w_ple_gate, D_MODEL, D_MODEL, WG, 64 * (r / 32), 32 * (r % 32), 32 * (r % 32), 32, scr, lane); continue; }
            r -= I_G;
            p0_transpose_item(w_ple_proj, D_PLE, D_MODEL, WP, 64 * (r / 32), 32 * (r % 32), 32 * (r % 32), 32, scr, lane);
        }
        { const int gt = vcu * (NWAVES * 64) + tid, NT = G * NWAVES * 64; u32x4* z = (u32x4*)(WIN + (size_t)5408 * D_MODEL);
          for (int i = gt; i < 224 * 128; i += NT) z[i] = (u32x4){0u, 0u, 0u, 0u}; }
        for (int m = gw; m < M; m += NGW) rms_row_to_bf16(x + (size_t)m * D_MODEL, norm_mix, XN + (size_t)m * D_MODEL, lane);
        { const int gt = vcu * (NWAVES * 64) + tid, NT = G * NWAVES * 64;
          for (int i = gt; i < M * D_PLE / 8; i += NT) { const f32x4 a = ((const f32x4*)p)[2 * i], b = ((const f32x4*)p)[2 * i + 1];
              u32x4 o; o.x = pk2(a[0], a[1]); o.y = pk2(a[2], a[3]); o.z = pk2(b[0], b[1]); o.w = pk2(b[2], b[3]); ((u32x4*)PB)[i] = o; } }
        { const int gt = vcu * (NWAVES * 64) + tid, NT = G * NWAVES * 64;
          for (int i = gt; i < M * 8; i += NT) { const int t = i >> 3, j = i & 7;
              const float inv_freq = powf(500000.0f, -(float)(2 * j) / 16.0f);
              const float ang = (float)positions[t] * inv_freq;
              ROPE[t * 16 + j] = cosf(ang); ROPE[t * 16 + 8 + j] = sinf(ang); } }
        if (BOTH(0)) xcd_barrier(bar);
    }
    if (IN(1)) {
        { pg8::Gemm g{XN, WIN, D_MODEL, D_MODEL, D_MODEL}; pg8::StaticOrder S; S.init(M, NZ_PAD, G, bx);
          pg8::EpiInProj E{ZA, ZY, GLOW, ROPE};
          pg8::gemm_phase<pg8::EpiInProj, pg8::StaticOrder, true>(lds, g, S, E); }
        { pg8::Gemm g{PB, WP, D_PLE, D_PLE, D_PLE}; pg8::StaticOrder S; S.init(M, D_MODEL, G, bx);
          pg8::EpiPlainBf16 E{PP, D_MODEL};
          pg8::gemm_phase<pg8::EpiPlainBf16, pg8::StaticOrder, false>(lds, g, S, E); }
        if (BOTH(1)) xcd_barrier(bar);
    }
    if (IN(2)) {
        for (int u = vcu; u < BATCH * ATT_KV_HEADS * (SEQ / 128); u += G) att::attn_unit(lds, u >> 7, (u >> 6) & 1, u & 63, ZA, ZY, sinks);
        for (int u = vcu; u < 256; u += G) gla::gla_unit<false>(lds, u, ZA, ZY, GLOW, w_gate_up, b_gate, gla_norm, LST, DTOT);
        if (BOTH(2)) xcd_barrier(bar);
    }
    if (IN(3)) {
        gla::gla_scan(vcu * (NWAVES * 64) + tid, G * NWAVES * 64, LST, DTOT);
        if (BOTH(3)) xcd_barrier(bar);
    }
    if (IN(4)) {
        for (int u = vcu; u < 256; u += G) gla::gla_unit<true>(lds, u, ZA, ZY, GLOW, w_gate_up, b_gate, gla_norm, LST, DTOT);
        if (BOTH(4)) xcd_barrier(bar);
    }
    if (IN(5)) {
        pg8::Gemm g{ZY, WOUT, ZY_P, D_MIX, D_MIX}; pg8::StaticOrder S; S.init(M, D_MODEL, G, bx);
        pg8::EpiOutProj E{x, out, HB, ple_norm, RSS1};
        pg8::gemm_phase<pg8::EpiOutProj, pg8::StaticOrder, false>(lds, g, S, E);
        if (BOTH(5)) xcd_barrier(bar);
    }
    if (IN(6)) {
        pg8::Gemm g{HB, WG, D_MODEL, D_MODEL, D_MODEL}; pg8::StaticOrder S; S.init(M, D_MODEL, G, bx);
        pg8::EpiGate E{out, PP, RSS1, RSS2};
        pg8::gemm_phase<pg8::EpiGate, pg8::StaticOrder, false>(lds, g, S, E);
        if (BOTH(6)) xcd_barrier(bar);
    }
    if (IN(7)) {
        for (int m = gw; m < M; m += NGW) {
            f32x4* xr = (f32x4*)(out + (size_t)m * D_MODEL) + lane; const f32x4* gr = (const f32x4*)final_norm + lane;
            const f32x4* rp = (const f32x4*)(RSS2 + (size_t)m * 16);
            const f32x4 rs = (rp[0] + rp[1]) + (rp[2] + rp[3]);
            const float r = 1.0f / sqrtf(((rs[0] + rs[1]) + (rs[2] + rs[3])) * (1.0f / D_MODEL) + EPS);
#pragma unroll
            for (int j = 0; j < 4; ++j) xr[64 * j] = xr[64 * j] * r * gr[64 * j];
        }
    }
#undef IN
#undef BOTH
}

extern "C" void kernel_launch(void* const* d_in, const int* in_sizes, int n_in, void* d_out, int out_size, void* d_ws, size_t ws_size, hipStream_t stream) {
    static int grid = 0;
    if (grid == 0) {
        if (n_in != 14 || out_size != M * D_MODEL || ws_size < WS_END) { fprintf(stderr, "kernel_launch: unexpected shapes (n_in %d out %d ws %zu)\n", n_in, out_size, ws_size); grid = -1; return; }
        int dev = 0, cus = 0, per_cu = 0;
        if (hipGetDevice(&dev) != hipSuccess || hipDeviceGetAttribute(&cus, hipDeviceAttributeMultiprocessorCount, dev) != hipSuccess) { grid = -1; return; }
        if (hipFuncSetAttribute((const void*)mk_fwd, hipFuncAttributeMaxDynamicSharedMemorySize, LDS_BYTES) != hipSuccess) { fprintf(stderr, "kernel_launch: hipFuncSetAttribute failed\n"); grid = -1; return; }
        if (hipOccupancyMaxActiveBlocksPerMultiprocessor(&per_cu, (const void*)mk_fwd, NWAVES * 64, LDS_BYTES) != hipSuccess || per_cu < 1)
            fprintf(stderr, "kernel_launch: occupancy query reports %d workgroups per CU\n", per_cu);
        (void)hipGetLastError();
        grid = cus;
    }
    if (grid < 0) return;
    (void)hipMemsetAsync((char*)d_ws + WS_CTL, 0, CTL_ZERO_BYTES, stream);
    Args a{};
    for (int i = 0; i < 14; ++i) a.in[i] = d_in[i];
    a.out = (float*)d_out; a.ws = (unsigned char*)d_ws;
    unsigned char* ws = (unsigned char*)d_ws;
    a.ph_lo = 0; a.ph_hi = 8; a.li = 0;
    hipLaunchKernelGGL(mk_fwd, dim3(grid), dim3(NWAVES * 64), LDS_BYTES, stream, a);
}
```
